# Optimizing an MI355X kernel written in HIP

```python
import jax, jax.numpy as jnp
from jax import lax
import numpy as np

D_MODEL = 1024
BATCH = 8
SEQ = 4096
DEPTH = 1
DEC_BATCH = 128
DEC_SEQ = 1
PAST_LEN = 16384
PAGE_SIZE = 128

HEAD_DIM = 64
MIX_WIDTH = D_MODEL
A_HEADS = MIX_WIDTH // 2 // HEAD_DIM
B_HEADS = MIX_WIDTH // 2 // HEAD_DIM
B_KV_HEADS = 2
B_GROUP = B_HEADS // B_KV_HEADS
DILATED_CONFIGS = ((128, 1), (512, 4), (2048, 16))
BAND = 128
A_WINDOW = 2048
B_WINDOW = 128
ROT_DIM = HEAD_DIM // 4
ROPE_THETA = 500000.0
ALPHA = (2 * DEPTH) ** 0.25
BETA = (8 * DEPTH) ** -0.25
LN_EPS = 1e-5
A_W = A_HEADS * HEAD_DIM
B_W = B_HEADS * HEAD_DIM
B_KV_W = B_KV_HEADS * HEAD_DIM
IN_SPLITS = (A_W, A_W, A_W, A_W, B_W, B_KV_W, B_KV_W, B_W)
IN_WIDTH = sum(IN_SPLITS)
SPLIT_IDX = tuple(int(c) for c in np.cumsum(IN_SPLITS)[:-1])

kernel_name = "hymba_dilated_swa_sink_deepnorm_step"


def _layer_norm(x, g, b):
    xf = x.astype(jnp.float32)
    mu = xf.mean(-1, keepdims=True)
    var = jnp.square(xf - mu).mean(-1, keepdims=True)
    return ((xf - mu) * lax.rsqrt(var + LN_EPS) * g.astype(jnp.float32) + b.astype(jnp.float32)).astype(x.dtype)


def _rope(x, pos):
    inv = ROPE_THETA ** (-jnp.arange(0, ROT_DIM, 2, dtype=jnp.float32) / ROT_DIM)
    ang = pos.astype(jnp.float32)[:, None] * inv[None, :]
    cos = jnp.cos(ang)[:, None, :]
    sin = jnp.sin(ang)[:, None, :]
    xf = x.astype(jnp.float32)
    x1 = xf[..., :ROT_DIM // 2]
    x2 = xf[..., ROT_DIM // 2:ROT_DIM]
    out = jnp.concatenate([x1 * cos - x2 * sin, x2 * cos + x1 * sin, xf[..., ROT_DIM:]], axis=-1)
    return out.astype(x.dtype)


def _project(x, pos, w_in):
    b, s, _ = x.shape
    h = jnp.einsum('bsd,de->bse', x, w_in)
    qa, ka, va, ga, qb, kb, vb, gb = jnp.split(h, SPLIT_IDX, axis=-1)
    qa = _rope(qa.reshape(b, s, A_HEADS, HEAD_DIM), pos)
    ka = _rope(ka.reshape(b, s, A_HEADS, HEAD_DIM), pos)
    va = va.reshape(b, s, A_HEADS, HEAD_DIM)
    qb = _rope(qb.reshape(b, s, B_HEADS, HEAD_DIM), pos)
    kb = _rope(kb.reshape(b, s, B_KV_HEADS, HEAD_DIM), pos)
    vb = vb.reshape(b, s, B_KV_HEADS, HEAD_DIM)
    return qa, ka, va, ga, qb, kb, vb, gb


def _dilate(x, d):
    b, s = x.shape[:2]
    rest = x.shape[2:]
    L = s // d
    xs = jnp.moveaxis(x.reshape(b, L, d, *rest), 2, 1).reshape(b * d, L, *rest)
    lp = -(-L // BAND) * BAND
    return jnp.pad(xs, [(0, 0), (0, lp - L)] + [(0, 0)] * len(rest))


def _undilate(y, b, s, d):
    L = s // d
    rest = y.shape[2:]
    y = y[:, :L].reshape(b, d, L, *rest)
    return jnp.moveaxis(y, 1, 2).reshape(b, s, *rest)


def _band_partial(q, k, v):
    n, L, hk, g, dh = q.shape
    nb = L // BAND
    qb = q.reshape(n, nb, BAND, hk, g, dh).astype(jnp.float32)
    kb = k.reshape(n, nb, BAND, hk, dh).astype(jnp.float32)
    vb = v.reshape(n, nb, BAND, hk, dh).astype(jnp.float32)
    kprev = jnp.pad(kb, ((0, 0), (1, 0), (0, 0), (0, 0), (0, 0)))[:, :-1]
    vprev = jnp.pad(vb, ((0, 0), (1, 0), (0, 0), (0, 0), (0, 0)))[:, :-1]
    kk = jnp.concatenate([kprev, kb], axis=2)
    vv = jnp.concatenate([vprev, vb], axis=2)
    sc = jnp.einsum('nbqhgd,nbkhd->nbhgqk', qb, kk) * (HEAD_DIM ** -0.5)
    qi = jnp.arange(BAND)[:, None]
    ki = jnp.arange(2 * BAND)[None, :]
    dist = BAND + qi - ki
    kpos = jnp.arange(nb)[:, None, None] * BAND - BAND + ki[None]
    valid = (dist >= 0) & (dist <= BAND) & (kpos >= 0)
    sc = jnp.where(valid[None, :, None, None], sc, -jnp.inf)
    m = sc.max(-1)
    p = jnp.exp(sc - m[..., None])
    den = p.sum(-1)
    o = jnp.einsum('nbhgqk,nbkhd->nbqhgd', p, vv).reshape(n, L, hk, g, dh)
    m = jnp.transpose(m, (0, 1, 4, 2, 3)).reshape(n, L, hk, g)
    den = jnp.transpose(den, (0, 1, 4, 2, 3)).reshape(n, L, hk, g)
    return m, den, o


def _strided_partial(q, kv_all, buf_len, dilation):
    t = q.shape[1]
    j = jnp.arange(BAND + 1)
    idx = buf_len + jnp.arange(t)[:, None] - dilation * j[None, :]
    valid = idx >= 0
    kv = kv_all[:, jnp.clip(idx, 0)].astype(jnp.float32)
    k = kv[:, :, :, 0]
    v = kv[:, :, :, 1]
    sc = jnp.einsum('nqhgd,nqkhd->nqhgk', q.astype(jnp.float32), k) * (HEAD_DIM ** -0.5)
    sc = jnp.where(valid[None, :, None, None, :], sc, -jnp.inf)
    m = sc.max(-1)
    p = jnp.exp(sc - m[..., None])
    den = p.sum(-1)
    o = jnp.einsum('nqhgk,nqkhd->nqhgd', p, v)
    return m, den, o


def _merge(parts, sink=None):
    m = parts[0][0]
    for pm, _, _ in parts[1:]:
        m = jnp.maximum(m, pm)
    if sink is not None:
        m = jnp.maximum(m, sink)
    den = 0.0
    num = 0.0
    for pm, ps, po in parts:
        w = jnp.exp(pm - m)
        den = den + ps * w
        num = num + po * w[..., None]
    if sink is not None:
        den = den + jnp.exp(sink - m)
    return num / den[..., None]


def _output(x, oa, ob, ga, gb, w_o, ln_g, ln_b):
    b, s, _ = x.shape
    mix = jnp.concatenate([oa.reshape(b, s, A_W).astype(x.dtype) * jax.nn.silu(ga),
                           ob.reshape(b, s, B_W).astype(x.dtype) * jax.nn.silu(gb)], axis=-1)
    out = jnp.einsum('bse,ed->bsd', mix, w_o)
    return _layer_norm(ALPHA * x + out, ln_g, ln_b)


def _prompt_layer(x, w_in, sinks, w_o, ln_g, ln_b):
    b, s, _ = x.shape
    pos = jnp.arange(s)
    qa, ka, va, ga, qb, kb, vb, gb = _project(x, pos, w_in)
    parts = []
    for _, d in DILATED_CONFIGS:
        m, den, o = _band_partial(_dilate(qa[:, :, :, None], d), _dilate(ka, d), _dilate(va, d))
        parts.append((_undilate(m, b, s, d), _undilate(den, b, s, d), _undilate(o, b, s, d)))
    oa = _merge(parts)
    qbg = qb.reshape(b, s, B_KV_HEADS, B_GROUP, HEAD_DIM)
    m, den, o = _band_partial(_dilate(qbg, 1), _dilate(kb, 1), _dilate(vb, 1))
    sink = sinks.astype(jnp.float32).reshape(B_KV_HEADS, B_GROUP)
    ob = _merge([(_undilate(m, b, s, 1), _undilate(den, b, s, 1), _undilate(o, b, s, 1))], sink)
    y = _output(x, oa, ob, ga, gb, w_o, ln_g, ln_b)
    wa = min(A_WINDOW, s)
    wb = min(B_WINDOW, s)
    kv_a = jnp.stack([ka[:, s - wa:], va[:, s - wa:]], axis=2)
    kv_b = jnp.stack([kb[:, s - wb:], vb[:, s - wb:]], axis=2)
    return y, kv_a, kv_b


def _sample_layer(x, kv_a_cache, kv_b_cache, w_in, sinks, w_o, ln_g, ln_b):
    b, t, _ = x.shape
    pos = PAST_LEN + jnp.arange(t)
    qa, ka, va, ga, qb, kb, vb, gb = _project(x, pos, w_in)
    new_a = jnp.stack([ka, va], axis=2)
    new_b = jnp.stack([kb, vb], axis=2)
    all_a = jnp.concatenate([kv_a_cache.astype(new_a.dtype), new_a], axis=1)
    all_b = jnp.concatenate([kv_b_cache.astype(new_b.dtype), new_b], axis=1)
    buf_a = kv_a_cache.shape[1]
    buf_b = kv_b_cache.shape[1]
    parts = [_strided_partial(qa[:, :, :, None], all_a, buf_a, d) for _, d in DILATED_CONFIGS]
    oa = _merge(parts)
    qbg = qb.reshape(b, t, B_KV_HEADS, B_GROUP, HEAD_DIM)
    sink = sinks.astype(jnp.float32).reshape(B_KV_HEADS, B_GROUP)
    ob = _merge([_strided_partial(qbg, all_b, buf_b, 1)], sink)
    y = _output(x, oa, ob, ga, gb, w_o, ln_g, ln_b)
    return y, new_a, new_b


def setup_inputs(seed: int = 0) -> dict:
    key = jax.random.key(seed)
    ks = jax.random.split(key, 9)
    buf_a = min(A_WINDOW, PAST_LEN)
    buf_b = min(B_WINDOW, PAST_LEN)
    x_prompt = jax.random.normal(ks[0], (BATCH, SEQ, D_MODEL), jnp.float32)
    x_sample = jax.random.normal(ks[1], (DEC_BATCH, DEC_SEQ, D_MODEL), jnp.float32)
    cache_a_kv = jax.random.normal(ks[2], (DEPTH, DEC_BATCH, buf_a, 2, A_HEADS, HEAD_DIM), jnp.float32)
    cache_b_kv = jax.random.normal(ks[3], (DEPTH, DEC_BATCH, buf_b, 2, B_KV_HEADS, HEAD_DIM), jnp.float32)
    w_in = jax.random.normal(ks[4], (DEPTH, D_MODEL, IN_WIDTH), jnp.float32) * D_MODEL ** -0.5
    attn_sinks = 0.5 * jax.random.normal(ks[5], (DEPTH, B_HEADS), jnp.float32)
    w_o = jax.random.normal(ks[6], (DEPTH, MIX_WIDTH, D_MODEL), jnp.float32) * (MIX_WIDTH ** -0.5 * BETA)
    ln_g = 1.0 + 0.05 * jax.random.normal(ks[7], (DEPTH, D_MODEL), jnp.float32)
    ln_b = 0.05 * jax.random.normal(ks[8], (DEPTH, D_MODEL), jnp.float32)
    return {"x_prompt": x_prompt, "x_sample": x_sample, "cache_a_kv": cache_a_kv, "cache_b_kv": cache_b_kv,
            "w_in": w_in, "attn_sinks": attn_sinks, "w_o": w_o, "ln_g": ln_g, "ln_b": ln_b}


def reference(x_prompt, x_sample, cache_a_kv, cache_b_kv, w_in, attn_sinks, w_o, ln_g, ln_b):
    yp = x_prompt
    ys = x_sample
    pa, pb, sa, sb = [], [], [], []
    for l in range(DEPTH):
        yp, kva, kvb = _prompt_layer(yp, w_in[l], attn_sinks[l], w_o[l], ln_g[l], ln_b[l])
        ys, nka, nkb = _sample_layer(ys, cache_a_kv[l], cache_b_kv[l], w_in[l], attn_sinks[l], w_o[l], ln_g[l], ln_b[l])
        pa.append(kva)
        pb.append(kvb)
        sa.append(nka)
        sb.append(nkb)
    prompt_a_kv = jnp.stack(pa)
    prompt_b_kv = jnp.stack(pb)
    sample_a_kv = jnp.stack(sa)
    sample_b_kv = jnp.stack(sb)
    return (yp, ys, prompt_a_kv, prompt_b_kv, sample_a_kv, sample_b_kv)
```

```cpp
#include <hip/hip_runtime.h>
#include <cstdio>
#include <cstdint>
#include <cmath>

constexpr int DM = 1024, NBATCH = 8, SEQ = 4096, MP = NBATCH * SEQ  , MS = 128  , MV = MP + MS  , MPAD = 33024  ;
constexpr int NIN = 3328;
constexpr float LN_EPS = 1e-5f;
constexpr float ALPHA = 1.189207115002721f;
constexpr float QSCALE = 0.125f * 1.4426950408889634f;
constexpr float LOG2E = 1.4426950408889634f;
constexpr size_t OFF_Y = 0;
constexpr size_t OFF_PA = 33685504;
constexpr size_t OFF_PB = 50462720;
constexpr size_t OFF_SA = 50724864;
constexpr size_t OFF_SB = 50855936;
constexpr size_t OUT_TOTAL = 50888704;
constexpr size_t MiB = 1u << 20;
constexpr size_t WS_CTL = 0, CTL_ZERO_BYTES = 1 * MiB;
constexpr size_t WS_ROPE = 1 * MiB;
constexpr size_t WS_WIN = 2 * MiB;
constexpr size_t WS_WO = 9 * MiB;
constexpr size_t WS_SQ = 11 * MiB;
constexpr size_t WS_XB = 16 * MiB;
constexpr size_t WS_QA = 96 * MiB, WS_KA = 128 * MiB, WS_VA = 160 * MiB;
constexpr size_t WS_QB = 192 * MiB;
constexpr size_t WS_KB = 224 * MiB, WS_VB = 232 * MiB;
constexpr size_t WS_G = 240 * MiB;
constexpr size_t WS_MIX = 320 * MiB;
constexpr size_t WS_END = 400 * MiB;
constexpr int CW_BAR = 4096;

namespace pg8 {
#define PG8_LAS __attribute__((address_space(3)))
typedef unsigned short bf16_t;
typedef short bf16x8 __attribute__((ext_vector_type(8)));
typedef float f32x4 __attribute__((ext_vector_type(4)));
typedef unsigned u32x4 __attribute__((ext_vector_type(4)));
constexpr int BM = 256, BK = 64, HALF = 128, HTB = HALF * BK * 2  , STAGE_BYTES = 8 * HTB, NXCD = 8, WGM = 8;

__host__ __device__ __forceinline__ int lds_byte(int r, int c) { const int st = (r >> 4) * 2 + (c >> 5), rr = r & 15, cc = c & 31, ob = rr * 64 + cc * 2; return st * 1024 + (ob ^ (((ob >> 9) & 1) << 5)); }
__host__ __device__ __forceinline__ void stage_rc(int b, int& R, int& C) { const int st = b / 1024, sb = b % 1024, swz = sb ^ (((sb >> 9) & 1) << 5); R = (st >> 1) * 16 + swz / 64; C = (st & 1) * 32 + (swz % 64) / 2; }
__host__ __device__ __forceinline__ int perm32(int rho) { const int n = rho >> 4, i = rho & 15; return 8 * (i >> 2) + 4 * n + (i & 3); }

struct Unit { int pm, pn; };
struct Gemm { const bf16_t* A; const bf16_t* Bt; int M, N, K; };

struct StaticOrder {
    int nM, nN, nwg, G, c;
    __host__ __device__ void init(int M, int N, int G_, int c_) { nM = M / BM; nN = N / BM; nwg = nM * nN; G = G_; c = c_; }
    __host__ __device__ bool next(int i, Unit& u) const {
        const long L = (long)i * G + c; if (L >= nwg) return false;
        int wgid = (int)L; { const int q = nwg / NXCD, r = nwg % NXCD, xcd = wgid % NXCD, off = wgid / NXCD; wgid = (xcd < r ? xcd * (q + 1) : r * (q + 1) + (xcd - r) * q) + off; }
        const int nig = WGM * nN, gid = wgid / nig, fm = gid * WGM, gsz = (nM - fm) < WGM ? (nM - fm) : WGM;
        u.pm = fm + ((wgid % nig) % gsz); u.pn = (wgid % nig) / gsz; return true;
    }
    __device__ __forceinline__ void a_ready(const Unit&) const {}
    __device__ __forceinline__ void done(const Unit&) const {}
};

__device__ __forceinline__ unsigned cvt_pk_bf16(float lo, float hi) { unsigned r; asm volatile("v_cvt_pk_bf16_f32 %0, %1, %2" : "=v"(r) : "v"(lo), "v"(hi)); return r; }
typedef float f32x2 __attribute__((ext_vector_type(2)));
struct EpiIn {
    static constexpr bool PERM = true, AFTER_DRAIN = false;
    float* out; unsigned char* ws; const float* rope;
    __device__ __forceinline__ void operator()(const f32x4 (&acc)[2][2][4][2], const Unit& u, int wr, int wc, int fr, int fq) const {
        const int pn = u.pn, pm = u.pm;
        const bool sample = (pm == MP / BM);
        bf16_t* QA = (bf16_t*)(ws + WS_QA); bf16_t* KA = (bf16_t*)(ws + WS_KA); bf16_t* VA = (bf16_t*)(ws + WS_VA);
        bf16_t* QB = (bf16_t*)(ws + WS_QB); bf16_t* KB = (bf16_t*)(ws + WS_KB); bf16_t* VB = (bf16_t*)(ws + WS_VB);
        bf16_t* G = (bf16_t*)(ws + WS_G); bf16_t* SQ = (bf16_t*)(ws + WS_SQ);
#pragma unroll
        for (int ai = 0; ai < 2; ++ai) {
            if (sample && ai == 1) continue;
#pragma unroll
            for (int m = 0; m < 4; ++m) {
                const int row = pm * BM + ai * HALF + wr * 64 + m * 16 + fr;
                const int pos = row & (SEQ - 1), b = row >> 12, bs = row - MP;
                const float* tp = rope + (size_t)(sample ? SEQ : pos) * 16;
#pragma unroll
                for (int bj = 0; bj < 2; ++bj) {
                    const int cg0 = pn * BM + bj * HALF;
                    const int cg = cg0 + wc * 32 + fq * 8;
                    float v[8];
#pragma unroll
                    for (int n = 0; n < 2; ++n)
#pragma unroll
                        for (int e = 0; e < 4; ++e) v[n * 4 + e] = acc[ai][bj][m][n][e];
                    const bool is_q = (cg0 < 512) || (cg0 >= 2048 && cg0 < 2560);
                    const bool do_rope = is_q || (cg0 >= 512 && cg0 < 1024) || (cg0 >= 2560 && cg0 < 2688);
                    if (do_rope && (wc & 1) == 0) {
                        const f32x4 c0 = *(const f32x4*)(tp), c1 = *(const f32x4*)(tp + 4), s0 = *(const f32x4*)(tp + 8), s1 = *(const f32x4*)(tp + 12);
                        const float cs[8] = {c0[0], c0[1], c0[2], c0[3], c1[0], c1[1], c1[2], c1[3]};
                        const float sn[8] = {s0[0], s0[1], s0[2], s0[3], s1[0], s1[1], s1[2], s1[3]};
#pragma unroll
                        for (int e = 0; e < 8; ++e) {
                            const float pv = __shfl_xor(v[e], 16);
                            const float r0 = v[e] * cs[e] - pv * sn[e];
                            const float r1 = v[e] * cs[e] + pv * sn[e];
                            v[e] = fq == 0 ? r0 : (fq == 1 ? r1 : v[e]);
                        }
                    }
                    if (is_q) {
#pragma unroll
                        for (int e = 0; e < 8; ++e) v[e] *= QSCALE;
                    }
                    u32x4 w; w.x = cvt_pk_bf16(v[0], v[1]); w.y = cvt_pk_bf16(v[2], v[3]); w.z = cvt_pk_bf16(v[4], v[5]); w.w = cvt_pk_bf16(v[6], v[7]);
                    const f32x4 f0 = {v[0], v[1], v[2], v[3]}, f1 = {v[4], v[5], v[6], v[7]};
                    if (cg0 < 512) {
                        if (sample) *(u32x4*)(SQ + (size_t)bs * 1024 + cg) = w;
                        else *(u32x4*)(QA + ((size_t)(b * 8 + (cg >> 6)) * SEQ + pos) * 64 + (cg & 63)) = w;
                    } else if (cg0 < 1536) {
                        const int kv = cg0 >= 1024 ? 1 : 0, c2 = cg - 512 - kv * 512;
                        if (sample) { float* o = out + OFF_SA + ((size_t)bs * 2 + kv) * 512 + c2; *(f32x4*)o = f0; *(f32x4*)(o + 4) = f1; }
                        else {
                            *(u32x4*)((kv ? VA : KA) + ((size_t)(b * 8 + (c2 >> 6)) * SEQ + pos) * 64 + (c2 & 63)) = w;
                            if (pos >= 2048) { float* o = out + OFF_PA + (((size_t)b * 2048 + (pos - 2048)) * 2 + kv) * 512 + c2; *(f32x4*)o = f0; *(f32x4*)(o + 4) = f1; }
                        }
                    } else if (cg0 < 2048) {
                        *(u32x4*)(G + (size_t)row * 1024 + (cg - 1536)) = w;
                    } else if (cg0 < 2560) {
                        const int c2 = cg - 2048;
                        if (sample) *(u32x4*)(SQ + (size_t)bs * 1024 + 512 + c2) = w;
                        else *(u32x4*)(QB + ((size_t)(b * 8 + (c2 >> 6)) * SEQ + pos) * 64 + (c2 & 63)) = w;
                    } else if (cg0 < 2816) {
                        const int kv = cg0 >= 2688 ? 1 : 0, c2 = cg - 2560 - kv * 128;
                        if (sample) { float* o = out + OFF_SB + ((size_t)bs * 2 + kv) * 128 + c2; *(f32x4*)o = f0; *(f32x4*)(o + 4) = f1; }
                        else {
                            *(u32x4*)((kv ? VB : KB) + ((size_t)(b * 2 + (c2 >> 6)) * SEQ + pos) * 64 + (c2 & 63)) = w;
                            if (pos >= SEQ - 128) { float* o = out + OFF_PB + (((size_t)b * 128 + (pos - (SEQ - 128))) * 2 + kv) * 128 + c2; *(f32x4*)o = f0; *(f32x4*)(o + 4) = f1; }
                        }
                    } else {
                        *(u32x4*)(G + (size_t)row * 1024 + 512 + (cg - 2816)) = w;
                    }
                }
            }
        }
    }
};
struct EpiOut {
    static constexpr bool PERM = false, AFTER_DRAIN = false;
    const float* xp; const float* xs; float* out;
    __device__ __forceinline__ void operator()(const f32x4 (&acc)[2][2][4][2], const Unit& u, int wr, int wc, int fr, int fq) const {
        const bool sample = (u.pm == MP / BM);
        const int col0 = u.pn * BM + wc * 32 + 4 * fq;
#pragma unroll
        for (int ai = 0; ai < 2; ++ai) {
            if (sample && ai == 1) continue;
#pragma unroll
            for (int m = 0; m < 4; ++m) {
                const int row = u.pm * BM + ai * HALF + wr * 64 + m * 16 + fr;
                const float* xr = sample ? xs + (size_t)(row - MP) * DM : xp + (size_t)row * DM;
                float* orow = out + OFF_Y + (size_t)row * DM;
#pragma unroll
                for (int bj = 0; bj < 2; ++bj)
#pragma unroll
                    for (int n = 0; n < 2; ++n) { const int c = col0 + bj * HALF + n * 16; const f32x4 xv = *(const f32x4*)(xr + c); *(f32x4*)(orow + c) = xv * ALPHA + acc[ai][bj][m][n]; }
            }
        }
    }
};

template <class Epi, class Sched, bool ALIGN_EPI = false, bool SP2 = false>
__device__ __forceinline__ void gemm_phase(PG8_LAS unsigned char* lds, const Gemm g, const Sched& S, const Epi& E) {
    const int tid = threadIdx.x, wid = __builtin_amdgcn_readfirstlane(tid >> 6), lane = tid & 63, wr = wid >> 2, wc = wid & 3, fr = lane & 15, fq = lane >> 4;
    const int K = g.K, nt = K / BK;
    unsigned voffA[2], voffB[2];
#pragma unroll
    for (int i = 0; i < 2; ++i) { int R, C; stage_rc(tid * 16 + i * 8192, R, C); const int Rb = Epi::PERM ? ((R & ~31) + perm32(R & 31)) : R;
        voffA[i] = (unsigned)(R * K + C) * 2u; voffB[i] = (unsigned)(Rb * K + C) * 2u; }
    const size_t kstep = (size_t)(BK * 2);
    const size_t hstep = (size_t)HALF * K * 2;
    const size_t tstep = 2 * hstep;
    const unsigned ldsw = (unsigned)wid * 1024u;
    const int aoff = lds_byte(wr * 64 + fr, fq * 8), boff = lds_byte(wc * 32 + fr, fq * 8);
#define PG8_SA(b, h) (((b) * 2 + (h)) * HTB)
#define PG8_SB(b, h) ((4 + (b) * 2 + (h)) * HTB)
#define PG8_STAGE(bufoff, gbase, voff) do { _Pragma("unroll") for (int _i = 0; _i < 2; ++_i) \
        __builtin_amdgcn_global_load_lds((const unsigned*)((const char*)(gbase) + (voff)[_i]), (PG8_LAS unsigned*)(lds + (bufoff) + ldsw + _i * 8192), 16, 0, 0); } while (0)
#define PG8_LDA(dst, b, h) do { _Pragma("unroll") for (int m = 0; m < 4; ++m) _Pragma("unroll") for (int k = 0; k < 2; ++k) dst[m][k] = *(const PG8_LAS bf16x8*)(lds + PG8_SA(b, h) + aoff + m * 2048 + k * 1024); } while (0)
#define PG8_LDB(dst, b, h) do { _Pragma("unroll") for (int n = 0; n < 2; ++n) _Pragma("unroll") for (int k = 0; k < 2; ++k) dst[n][k] = *(const PG8_LAS bf16x8*)(lds + PG8_SB(b, h) + boff + n * 2048 + k * 1024); } while (0)
#define PG8_MMA(ai, bj, At, Bt) do { __builtin_amdgcn_s_setprio(1); _Pragma("unroll") for (int m = 0; m < 4; ++m) _Pragma("unroll") for (int n = 0; n < 2; ++n) _Pragma("unroll") for (int k = 0; k < 2; ++k) \
        acc[ai][bj][m][n] = __builtin_amdgcn_mfma_f32_16x16x32_bf16(Bt[n][k], At[m][k], acc[ai][bj][m][n], 0, 0, 0); __builtin_amdgcn_s_setprio(0); } while (0)
#define PG8_WAIT_V(n) asm volatile("s_waitcnt vmcnt(" #n ")" ::: "memory")
#define PG8_WAIT_L(n) asm volatile("s_waitcnt lgkmcnt(" #n ")" ::: "memory")
#define PG8_BAR __builtin_amdgcn_s_barrier()
#define PG8_SCHED __builtin_amdgcn_sched_barrier(0)
    Unit cur, nxt; int ui = 0;
    if (!S.next(0, cur)) return;
    f32x4 acc[2][2][4][2];
#pragma unroll
    for (int a = 0; a < 2; ++a)
#pragma unroll
        for (int b = 0; b < 2; ++b)
#pragma unroll
            for (int m = 0; m < 4; ++m)
#pragma unroll
                for (int n = 0; n < 2; ++n) acc[a][b][m][n] = (f32x4){0.f, 0.f, 0.f, 0.f};
    bf16x8 At[4][2], B0[2][2], B1[2][2];
    const char* cA = (const char*)g.A + (size_t)cur.pm * tstep; const char* cB = (const char*)g.Bt + (size_t)cur.pn * tstep;
    S.a_ready(cur);
    if constexpr (SP2) {
        PG8_STAGE(PG8_SB(0, 0), cB, voffB); PG8_STAGE(PG8_SB(0, 1), cB + hstep, voffB); PG8_STAGE(PG8_SA(0, 0), cA, voffA); PG8_STAGE(PG8_SA(0, 1), cA + hstep, voffA);
        if (wr == 1) PG8_BAR;
        PG8_WAIT_V(2); PG8_BAR;
        PG8_STAGE(PG8_SB(1, 0), cB + kstep, voffB); PG8_STAGE(PG8_SA(1, 0), cA + kstep, voffA); PG8_STAGE(PG8_SB(1, 1), cB + hstep + kstep, voffB);
        PG8_WAIT_V(6); PG8_BAR;
    } else {
        PG8_STAGE(PG8_SB(0, 0), cB, voffB); PG8_STAGE(PG8_SA(0, 0), cA, voffA); PG8_STAGE(PG8_SB(0, 1), cB + hstep, voffB); PG8_STAGE(PG8_SA(0, 1), cA + hstep, voffA);
        if (wr == 1) PG8_BAR;
        PG8_WAIT_V(4); PG8_BAR;
        PG8_STAGE(PG8_SB(1, 0), cB + kstep, voffB); PG8_STAGE(PG8_SA(1, 0), cA + kstep, voffA); PG8_STAGE(PG8_SB(1, 1), cB + hstep + kstep, voffB);
        PG8_WAIT_V(6); PG8_BAR;
    }
    for (;;) {
        const bool has_next = S.next(ui + 1, nxt);
        const char* nA = has_next ? (const char*)g.A + (size_t)nxt.pm * tstep : cA; const char* nB = has_next ? (const char*)g.Bt + (size_t)nxt.pn * tstep : cB;
        for (int t = 0; t < nt; t += 2) {
            const bool last = (t == nt - 2);
            const char* a1 = cA + (size_t)(t + 1) * kstep;
            const char* a2 = last ? nA : cA + (size_t)(t + 2) * kstep; const char* b2 = last ? nB : cB + (size_t)(t + 2) * kstep;
            const char* a3 = a2 + kstep; const char* b3 = b2 + kstep;
            if (last && has_next) S.a_ready(nxt);
            if constexpr (SP2) {
            PG8_LDB(B0, 0, 0); PG8_LDB(B1, 0, 1); PG8_SCHED; PG8_LDA(At, 0, 0); PG8_STAGE(PG8_SA(1, 1), a1 + hstep, voffA);
            PG8_WAIT_V(8); PG8_WAIT_L(0); PG8_BAR; PG8_MMA(0, 0, At, B0); PG8_MMA(0, 1, At, B1); PG8_BAR; PG8_SCHED;
            PG8_LDA(At, 0, 1); PG8_STAGE(PG8_SB(0, 0), b2, voffB); PG8_STAGE(PG8_SB(0, 1), b2 + hstep, voffB); PG8_STAGE(PG8_SA(0, 0), a2, voffA);
            PG8_WAIT_V(8); PG8_WAIT_L(0); PG8_BAR; PG8_MMA(1, 0, At, B0); PG8_MMA(1, 1, At, B1); PG8_BAR; PG8_SCHED;
            PG8_LDB(B0, 1, 0); PG8_LDB(B1, 1, 1); PG8_SCHED; PG8_LDA(At, 1, 0); PG8_STAGE(PG8_SA(0, 1), a2 + hstep, voffA);
            PG8_WAIT_V(8); PG8_WAIT_L(0); PG8_BAR; PG8_MMA(0, 0, At, B0); PG8_MMA(0, 1, At, B1); PG8_BAR; PG8_SCHED;
            PG8_LDA(At, 1, 1); PG8_STAGE(PG8_SB(1, 0), b3, voffB); PG8_STAGE(PG8_SB(1, 1), b3 + hstep, voffB); PG8_STAGE(PG8_SA(1, 0), a3, voffA);
            PG8_WAIT_V(8); PG8_WAIT_L(0); PG8_BAR; PG8_MMA(1, 0, At, B0); PG8_MMA(1, 1, At, B1); PG8_BAR; PG8_SCHED;
            } else {
            PG8_LDB(B0, 0, 0); PG8_SCHED; PG8_LDA(At, 0, 0); PG8_STAGE(PG8_SA(1, 1), a1 + hstep, voffA);
            PG8_WAIT_L(8); PG8_BAR; PG8_WAIT_L(0); PG8_MMA(0, 0, At, B0); PG8_BAR; PG8_SCHED;
            PG8_LDB(B1, 0, 1); PG8_STAGE(PG8_SB(0, 0), b2, voffB);
            PG8_BAR; PG8_WAIT_L(0); PG8_MMA(0, 1, At, B1); PG8_BAR;
            PG8_LDA(At, 0, 1); PG8_STAGE(PG8_SA(0, 0), a2, voffA);
            PG8_BAR; PG8_WAIT_L(0); PG8_MMA(1, 0, At, B0); PG8_BAR; PG8_SCHED;
            PG8_STAGE(PG8_SB(0, 1), b2 + hstep, voffB);
            PG8_WAIT_V(6); PG8_BAR; PG8_MMA(1, 1, At, B1); PG8_BAR;
            PG8_LDB(B0, 1, 0); PG8_SCHED; PG8_LDA(At, 1, 0); PG8_STAGE(PG8_SA(0, 1), a2 + hstep, voffA);
            PG8_WAIT_L(8); PG8_BAR; PG8_WAIT_L(0); PG8_MMA(0, 0, At, B0); PG8_BAR; PG8_SCHED;
            PG8_LDB(B1, 1, 1); PG8_STAGE(PG8_SB(1, 0), b3, voffB);
            PG8_BAR; PG8_WAIT_L(0); PG8_MMA(0, 1, At, B1); PG8_BAR;
            PG8_LDA(At, 1, 1); PG8_STAGE(PG8_SA(1, 0), a3, voffA);
            PG8_BAR; PG8_WAIT_L(0); PG8_MMA(1, 0, At, B0); PG8_BAR; PG8_SCHED;
            PG8_STAGE(PG8_SB(1, 1), b3 + hstep, voffB);
            PG8_WAIT_V(6); PG8_BAR; PG8_MMA(1, 1, At, B1); PG8_BAR;
            }
        }
        if constexpr (ALIGN_EPI) { if (wr == 0) PG8_BAR; }
        if constexpr (!Epi::AFTER_DRAIN) { E(acc, cur, wr, wc, fr, fq); S.done(cur); }
        if (!has_next) break;
#pragma unroll
        for (int a = 0; a < 2; ++a)
#pragma unroll
            for (int b = 0; b < 2; ++b)
#pragma unroll
                for (int m = 0; m < 4; ++m)
#pragma unroll
                    for (int n = 0; n < 2; ++n) acc[a][b][m][n] = (f32x4){0.f, 0.f, 0.f, 0.f};
        cur = nxt; cA = nA; cB = nB; ++ui;
        if constexpr (ALIGN_EPI) { if (wr == 1) PG8_BAR; }
    }
    PG8_WAIT_V(0);
    if constexpr (!ALIGN_EPI) { if (wr == 0) PG8_BAR; }
    PG8_BAR;
    if constexpr (Epi::AFTER_DRAIN) { E.fused(acc, cur, wr, wc, fr, fq, lds, wid, lane); S.done(cur); }
#undef PG8_SA
#undef PG8_SB
#undef PG8_STAGE
#undef PG8_LDA
#undef PG8_LDB
#undef PG8_MMA
#undef PG8_WAIT_V
#undef PG8_WAIT_L
#undef PG8_BAR
#undef PG8_SCHED
}
}
#define GAS __attribute__((address_space(1)))
#define LAS __attribute__((address_space(3)))
typedef unsigned short bf16;
typedef unsigned v4u __attribute__((ext_vector_type(4)));
typedef float f32x4 __attribute__((ext_vector_type(4)));
typedef short bf16x8 __attribute__((ext_vector_type(8)));
typedef GAS unsigned gu32;
typedef GAS unsigned long long gu64;
#define RLX_AGENT __ATOMIC_RELAXED, __HIP_MEMORY_SCOPE_AGENT
#define LDS_WAIT() asm volatile("s_waitcnt lgkmcnt(0)" ::: "memory")
#define VM_WAIT() asm volatile("s_waitcnt vmcnt(0)" ::: "memory")
__device__ __forceinline__ unsigned long long rt() { return __builtin_amdgcn_s_memrealtime(); }
__device__ __forceinline__ unsigned f2bf(float f) { unsigned u = __builtin_bit_cast(unsigned, f); return (u + 0x7fffu + ((u >> 16) & 1u)) >> 16; }
__device__ __forceinline__ unsigned pk2(float lo, float hi) { return f2bf(lo) | (f2bf(hi) << 16); }
#define XB_TMO      128
#define XB_XCNT(j)  (256  + 64 * (j))
#define XB_XSUB(j)  (1280 + 64 * (j))
#define XB_XGEN(j)  (2304 + 64 * (j))
#define XB_TOP      3328
#define XB_TOPGEN   3392
#define XCD_BAR_WORDS 3456
#define XB_SPIN_CAP (1u << 18)

__device__ __forceinline__ unsigned xb_ld(unsigned* p)              { return __hip_atomic_load(p, __ATOMIC_RELAXED, __HIP_MEMORY_SCOPE_AGENT); }
__device__ __forceinline__ unsigned xb_add(unsigned* p, unsigned v) { return __hip_atomic_fetch_add(p, v, __ATOMIC_RELAXED, __HIP_MEMORY_SCOPE_AGENT); }
__device__ __forceinline__ unsigned xb_xcc_id() { return (unsigned)__builtin_amdgcn_s_getreg((3 << 11) | 20) & 0xFu; }
#define XB_SPIN(cond, bar) do { unsigned _sp = 0; while (cond) { __builtin_amdgcn_s_sleep(1); \
    if ((++_sp & 255u) == 0u) { if (xb_ld(&(bar)[XB_TMO])) break; if (_sp > XB_SPIN_CAP) { atomicAdd(&(bar)[XB_TMO], 1u); break; } } } } while (0)

struct XcdBarrier {
    unsigned* bar; unsigned x;
    volatile LAS unsigned* st;
};

__device__ __forceinline__ XcdBarrier xcd_barrier_post(unsigned* bar, volatile LAS unsigned* st) {
    XcdBarrier b; b.bar = bar; b.x = xb_xcc_id(); b.st = st;
    if (threadIdx.x == 0) (void)xb_add(&bar[XB_XCNT(b.x)], 1u);
    return b;
}
__device__ __forceinline__ void xcd_barrier_complete(unsigned* bar, unsigned x, unsigned& nloc, unsigned& nx) {
    const unsigned G = gridDim.x * gridDim.y * gridDim.z;
    unsigned sum, cnt, mine, sp = 0u;
    for (;;) {
        sum = 0u; cnt = 0u; mine = 0u;
#pragma unroll
        for (unsigned j = 0; j < 16; ++j) { const unsigned c = xb_ld(&bar[XB_XCNT(j)]); sum += c; cnt += (c > 0u) ? 1u : 0u; mine = (j == x) ? c : mine; }
        if (sum == G) break;
        __builtin_amdgcn_s_sleep(1);
        if ((++sp & 255u) == 0u) { if (xb_ld(&bar[XB_TMO])) break; if (sp > XB_SPIN_CAP) { atomicAdd(&bar[XB_TMO], 1u); break; } }
    }
    nloc = mine > 0u ? mine : 1u; nx = cnt > 0u ? cnt : 1u;
}

__device__ __forceinline__ void xcd_barrier(const XcdBarrier& b) {
    asm volatile("s_waitcnt vmcnt(0)" ::: "memory");
    __syncthreads();
    if (threadIdx.x == 0) {
        unsigned* bar = b.bar;
        __builtin_amdgcn_s_waitcnt(0);
        unsigned nloc = b.st[0], nx = b.st[1];
        if (nloc == 0u) { xcd_barrier_complete(bar, b.x, nloc, nx); b.st[0] = nloc; b.st[1] = nx; }
        const unsigned old = xb_add(&bar[XB_XSUB(b.x)], 1u);
        const unsigned gen = old / nloc;
        if (old + 1u == (gen + 1u) * nloc) {
            __builtin_amdgcn_fence(__ATOMIC_RELEASE, "agent");
            asm volatile("s_waitcnt vmcnt(0)" ::: "memory");
            const unsigned og = xb_add(&bar[XB_TOP], 1u);
            const unsigned tg = og / nx;
            if (og + 1u == (tg + 1u) * nx) xb_add(&bar[XB_TOPGEN], 1u);
            else XB_SPIN(xb_ld(&bar[XB_TOPGEN]) == tg, bar);
            __builtin_amdgcn_fence(__ATOMIC_ACQUIRE, "agent");
            xb_add(&bar[XB_XGEN(b.x)], 1u);
            asm volatile("s_waitcnt vmcnt(0)" ::: "memory");
        } else {
            XB_SPIN(xb_ld(&bar[XB_XGEN(b.x)]) == gen, bar);
            __builtin_amdgcn_fence(__ATOMIC_ACQUIRE, "agent");
            asm volatile("s_waitcnt vmcnt(0)" ::: "memory");
        }
    }
    __syncthreads();
}
__device__ __forceinline__ float wave_sum(float v) {
#pragma unroll
    for (int o = 1; o < 64; o <<= 1) v += __shfl_xor(v, o);
    return v;
}
__device__ __forceinline__ void p0_transpose_item(const float* W, int K, int N, bf16* WT, int row_off, LAS float* scr, int item, int lane) {
    const int nblk = N / 32, kb = item / nblk, nb = item % nblk, k0 = 64 * kb, n0 = 32 * nb;
#pragma unroll 8
    for (int i = 0; i < 32; ++i) { const int kk = 2 * i + (lane >> 5); scr[kk * 33 + (lane & 31)] = W[(size_t)(k0 + kk) * N + n0 + (lane & 31)]; }
    LDS_WAIT(); asm volatile("" ::: "memory");
    const int c = lane & 7;
#pragma unroll
    for (int j = 0; j < 4; ++j) { const int n = (lane >> 3) + 8 * j; const LAS float* s = scr + (8 * c) * 33 + n;
        v4u o; o.x = pk2(s[0 * 33], s[1 * 33]); o.y = pk2(s[2 * 33], s[3 * 33]); o.z = pk2(s[4 * 33], s[5 * 33]); o.w = pk2(s[6 * 33], s[7 * 33]);
        *(GAS v4u*)(WT + (size_t)(row_off + n0 + n) * K + k0 + 8 * c) = o; }
    LDS_WAIT(); asm volatile("" ::: "memory");
}
namespace att {
typedef short bf16x8 __attribute__((ext_vector_type(8)));
typedef short s16x4 __attribute__((ext_vector_type(4)));
typedef float f32x16 __attribute__((ext_vector_type(16)));
typedef float f32x4 __attribute__((ext_vector_type(4)));
typedef unsigned u32x4 __attribute__((ext_vector_type(4)));
typedef unsigned u32x2 __attribute__((ext_vector_type(2)));
typedef unsigned short u16;
#define ALDS __attribute__((address_space(3)))
constexpr int L_OBUF = 0;
constexpr int L_LBUF = 65536;
constexpr int L_WAVE = 69632;
constexpr int L_WAVE_STRIDE = 4096 + 256;
static_assert(L_WAVE + 8 * L_WAVE_STRIDE <= 131072, "attention LDS map");

__device__ __forceinline__ int crow(int r, int hi) { return (r & 3) + 8 * (r >> 2) + 4 * hi; }
__device__ __forceinline__ unsigned cvtpk(float lo, float hi) { typedef float f2 __attribute__((ext_vector_type(2))); typedef __bf16 b2 __attribute__((ext_vector_type(2)));
    f2 v = {lo, hi}; b2 b = __builtin_convertvector(v, b2); return __builtin_bit_cast(unsigned, b); }
__device__ __forceinline__ float bf2f(unsigned u) { return __uint_as_float(u << 16); }
__device__ __forceinline__ float ex2(float x) { return __builtin_amdgcn_exp2f(x); }
__device__ __forceinline__ float lg2(float x) { return __builtin_amdgcn_logf(x); }
__device__ __forceinline__ float swapmax(float x) { auto rr = __builtin_amdgcn_permlane32_swap(__float_as_uint(x), __float_as_uint(x), false, false); return fmaxf(__uint_as_float(rr[0]), __uint_as_float(rr[1])); }
__device__ __forceinline__ float swapsum(float x) { auto rr = __builtin_amdgcn_permlane32_swap(__float_as_uint(x), __float_as_uint(x), false, false); return __uint_as_float(rr[0]) + __uint_as_float(rr[1]); }
__device__ __forceinline__ float silu(float g) { return g * __builtin_amdgcn_rcpf(1.0f + ex2(-g * LOG2E)); }
typedef short v4i16_t __attribute__((ext_vector_type(4)));
__device__ __forceinline__ s16x4 vtr(ALDS const unsigned char* p) { return __builtin_bit_cast(s16x4, __builtin_amdgcn_ds_read_tr16_b64_v4i16((ALDS v4i16_t*)p)); }

__device__ __forceinline__ void band_tile(const u16* __restrict__ Qp, const u16* __restrict__ Kp, const u16* __restrict__ Vp, int stride, int res, int i0,
                                          ALDS unsigned char* vst, ALDS float* wsf, int lane, f32x16& o0, f32x16& o1, float& m_out, float& l_out) {
    const int r32 = lane & 31, hi = lane >> 5;
    bf16x8 qr[4];
    { const u16* qrow = Qp + (size_t)((i0 + r32) * stride + res) * 64 + hi * 8;
#pragma unroll
      for (int d0 = 0; d0 < 4; ++d0) qr[d0] = *(const bf16x8*)(qrow + d0 * 16); }
#pragma unroll
    for (int r = 0; r < 16; ++r) { o0[r] = 0.f; o1[r] = 0.f; }
    float m = -INFINITY, l = 0.f;
    const int nt = (i0 >> 5) + 1 < 5 ? (i0 >> 5) + 1 : 5;
    ALDS const unsigned char* vrd = vst + (4 * hi + ((lane & 15) >> 2)) * 64 + ((lane >> 4) & 1) * 32 + (lane & 3) * 8;
    for (int kt = 0; kt < nt; ++kt) {
        const int j0 = i0 - 32 * kt;
        const u16* krow = Kp + (size_t)((j0 + r32) * stride + res) * 64 + hi * 8;
        bf16x8 kf[4];
#pragma unroll
        for (int d0 = 0; d0 < 4; ++d0) kf[d0] = *(const bf16x8*)(krow + d0 * 16);
        u32x4 vr[4];
#pragma unroll
        for (int dh = 0; dh < 2; ++dh)
#pragma unroll
            for (int kg = 0; kg < 2; ++kg) vr[dh * 2 + kg] = *(const u32x4*)(Vp + (size_t)((j0 + 16 * kg + (lane >> 2)) * stride + res) * 64 + dh * 32 + (lane & 3) * 8);
        f32x16 p;
#pragma unroll
        for (int r = 0; r < 16; ++r) p[r] = 0.f;
#pragma unroll
        for (int d0 = 0; d0 < 4; ++d0) p = __builtin_amdgcn_mfma_f32_32x32x16_bf16(kf[d0], qr[d0], p, 0, 0, 0);
        if (kt == 0) {
#pragma unroll
            for (int r = 0; r < 16; ++r) if (crow(r, hi) > r32) p[r] = -INFINITY;
        }
        if (kt == 4) {
#pragma unroll
            for (int r = 0; r < 16; ++r) if (crow(r, hi) < r32) p[r] = -INFINITY;
        }
        float rm = fmaxf(p[0], p[1]);
#pragma unroll
        for (int r = 2; r < 16; ++r) rm = fmaxf(rm, p[r]);
        rm = swapmax(rm);
        const float mn = fmaxf(m, rm);
        const float alpha = ex2(m - mn);
        float ps = 0.f;
#pragma unroll
        for (int r = 0; r < 16; ++r) { p[r] = ex2(p[r] - mn); ps += p[r]; }
        l = l * alpha + ps; m = mn;
        u32x4 pw0, pw1;
        pw0.x = cvtpk(p[0], p[1]); pw0.y = cvtpk(p[2], p[3]); pw0.z = cvtpk(p[4], p[5]); pw0.w = cvtpk(p[6], p[7]);
        pw1.x = cvtpk(p[8], p[9]); pw1.y = cvtpk(p[10], p[11]); pw1.z = cvtpk(p[12], p[13]); pw1.w = cvtpk(p[14], p[15]);
        const bf16x8 pa0 = __builtin_bit_cast(bf16x8, pw0), pa1 = __builtin_bit_cast(bf16x8, pw1);
        if (kt > 0) {
            if (hi == 0) wsf[r32] = alpha;
#pragma unroll
            for (int r = 0; r < 16; ++r) { const float a = wsf[crow(r, hi)]; o0[r] *= a; o1[r] *= a; }
        }
#pragma unroll
        for (int i = 0; i < 4; ++i) *(ALDS u32x4*)(vst + i * 1024 + lane * 16) = vr[i];
#pragma unroll
        for (int d0 = 0; d0 < 2; ++d0) {
            const s16x4 a0 = vtr(vrd + d0 * 2048), a1 = vtr(vrd + d0 * 2048 + 512), b0 = vtr(vrd + d0 * 2048 + 1024), b1 = vtr(vrd + d0 * 2048 + 1536);
            const bf16x8 vf0 = {a0[0], a0[1], a0[2], a0[3], a1[0], a1[1], a1[2], a1[3]};
            const bf16x8 vf1 = {b0[0], b0[1], b0[2], b0[3], b1[0], b1[1], b1[2], b1[3]};
            if (d0 == 0) { o0 = __builtin_amdgcn_mfma_f32_32x32x16_bf16(pa0, vf0, o0, 0, 0, 0); o0 = __builtin_amdgcn_mfma_f32_32x32x16_bf16(pa1, vf1, o0, 0, 0, 0); }
            else         { o1 = __builtin_amdgcn_mfma_f32_32x32x16_bf16(pa0, vf0, o1, 0, 0, 0); o1 = __builtin_amdgcn_mfma_f32_32x32x16_bf16(pa1, vf1, o1, 0, 0, 0); }
        }
    }
    l_out = swapsum(l); m_out = m;
}

__device__ __forceinline__ void gate_store(ALDS const unsigned char* src, const u16* __restrict__ G, u16* __restrict__ MIX, size_t row0, int col, int lane) {
#pragma unroll
    for (int it = 0; it < 4; ++it) {
        const int idx = it * 64 + lane, rr = idx >> 3, ch = idx & 7;
        const u32x4 ov = *(ALDS const u32x4*)(src + rr * 128 + ch * 16);
        const size_t off = (row0 + rr) * 1024 + col + ch * 8;
        const u32x4 gv = *(const u32x4*)(G + off);
        u32x4 w;
#pragma unroll
        for (int e = 0; e < 4; ++e) {
            const float o_lo = bf2f(ov[e] & 0xffffu), o_hi = __uint_as_float(ov[e] & 0xffff0000u);
            const float g_lo = bf2f(gv[e] & 0xffffu), g_hi = __uint_as_float(gv[e] & 0xffff0000u);
            w[e] = cvtpk(o_lo * silu(g_lo), o_hi * silu(g_hi));
        }
        *(u32x4*)(MIX + off) = w;
    }
}

__device__ __forceinline__ float red16(float s) { s += __shfl_xor(s, 1); s += __shfl_xor(s, 2); s += __shfl_xor(s, 4); s += __shfl_xor(s, 8); return s; }
__device__ __forceinline__ void sample_job(int bs, int head16, const float* __restrict__ cache_a, const float* __restrict__ cache_b, const float* __restrict__ sinks,
                                           const float* out, const u16* __restrict__ SQ, const u16* __restrict__ G, u16* __restrict__ MIX, int lane) {
    const int sub = lane & 15, g = lane >> 4;
    const bool isA = head16 < 8; const int h = head16 & 7;
    float q[4];
    { const u32x2 qv = *(const u32x2*)(SQ + (size_t)bs * 1024 + head16 * 64 + 4 * sub); q[0] = bf2f(qv.x & 0xffffu); q[1] = __uint_as_float(qv.x & 0xffff0000u); q[2] = bf2f(qv.y & 0xffffu); q[3] = __uint_as_float(qv.y & 0xffff0000u); }
    const float* Kc; size_t pitch; int voff, nrows; const float* selfk; float mult;
    if (isA) { Kc = cache_a + (size_t)bs * 2048 * 1024 + h * 64 + 4 * sub; pitch = 1024; voff = 512; nrows = 384; selfk = out + OFF_SA + (size_t)bs * 1024 + h * 64 + 4 * sub; mult = 3.f; }
    else { const int kvh = h >> 2; Kc = cache_b + (size_t)bs * 128 * 256 + kvh * 64 + 4 * sub; pitch = 256; voff = 128; nrows = 128; selfk = out + OFF_SB + (size_t)bs * 256 + kvh * 64 + 4 * sub; mult = 1.f; }
    float m, l, o[4];
    { const f32x4 k = *(const f32x4*)selfk, v = *(const f32x4*)(selfk + voff);
      const float s = red16(q[0] * k[0] + q[1] * k[1] + q[2] * k[2] + q[3] * k[3]);
      if (g == 0) { m = s; l = mult; o[0] = mult * v[0]; o[1] = mult * v[1]; o[2] = mult * v[2]; o[3] = mult * v[3]; }
      else { m = -INFINITY; l = 0.f; o[0] = o[1] = o[2] = o[3] = 0.f; } }
    for (int it0 = 0; it0 < nrows / 4; it0 += 8) {
        f32x4 kk[8], vv[8];
#pragma unroll
        for (int i = 0; i < 8; ++i) {
            const int e = 4 * (it0 + i) + g;
            int row;
            if (isA) { const int c = e >> 7, j = (e & 127) + 1; row = 2048 - (j << (2 * c)); } else row = 127 - e;
            const float* p = Kc + (size_t)row * pitch;
            kk[i] = *(const f32x4*)p; vv[i] = *(const f32x4*)(p + voff);
        }
#pragma unroll
        for (int i = 0; i < 8; ++i) {
            const float s = red16(q[0] * kk[i][0] + q[1] * kk[i][1] + q[2] * kk[i][2] + q[3] * kk[i][3]);
            const float mn = fmaxf(m, s), a = ex2(m - mn), p = ex2(s - mn);
            l = l * a + p; m = mn;
#pragma unroll
            for (int e = 0; e < 4; ++e) o[e] = o[e] * a + p * vv[i][e];
        }
    }
    float M = fmaxf(m, __shfl_xor(m, 16)); M = fmaxf(M, __shfl_xor(M, 32));
    const float f = ex2(m - M);
    l *= f; l += __shfl_xor(l, 16); l += __shfl_xor(l, 32);
#pragma unroll
    for (int e = 0; e < 4; ++e) { o[e] *= f; o[e] += __shfl_xor(o[e], 16); o[e] += __shfl_xor(o[e], 32); }
    if (!isA) { const float s2 = sinks[h] * LOG2E, M2 = fmaxf(M, s2), f2 = ex2(M - M2); l = l * f2 + ex2(s2 - M2);
#pragma unroll
        for (int e = 0; e < 4; ++e) o[e] *= f2; }
    const float il = 1.0f / l;
    const size_t off = (size_t)(MP + bs) * 1024 + head16 * 64 + 4 * sub;
    const u32x2 gv = *(const u32x2*)(G + off);
    const float g0 = bf2f(gv.x & 0xffffu), g1 = __uint_as_float(gv.x & 0xffff0000u), g2 = bf2f(gv.y & 0xffffu), g3 = __uint_as_float(gv.y & 0xffff0000u);
    u32x2 w; w.x = cvtpk(o[0] * il * silu(g0), o[1] * il * silu(g1)); w.y = cvtpk(o[2] * il * silu(g2), o[3] * il * silu(g3));
    if (g == 0) *(u32x2*)(MIX + off) = w;
}

__device__ __forceinline__ void a_unit(int u, const unsigned char* ws, ALDS unsigned char* lds, int wave, int lane) {
    const int b = u >> 6, h = (u >> 3) & 7, blk = u & 7;
    const size_t hb = (size_t)(b * 8 + h) * SEQ * 64;
    const u16* Qp = (const u16*)(ws + WS_QA) + hb; const u16* Kp = (const u16*)(ws + WS_KA) + hb; const u16* Vp = (const u16*)(ws + WS_VA) + hb;
    const u16* G = (const u16*)(ws + WS_G); u16* MIX = (u16*)(ws + WS_MIX);
    ALDS unsigned char* obuf = lds + L_OBUF; ALDS float* lbuf = (ALDS float*)(lds + L_LBUF);
    ALDS unsigned char* vst = lds + L_WAVE + wave * L_WAVE_STRIDE; ALDS float* wsf = (ALDS float*)(vst + 4096);
    const int r32 = lane & 31, hi = lane >> 5;
    for (int st = 0; st < 3; ++st) {
        for (int tt = 0; tt < 2; ++tt) {
            const int tile = wave * 2 + tt;
            int stride, res, i0, tstride, tbase;
            if (st == 0) { stride = 16; res = tile; i0 = 32 * blk; tstride = 16; tbase = tile; }
            else if (st == 1) { stride = 4; res = tile >> 2; i0 = 128 * blk + 32 * (tile & 3); tstride = 4; tbase = 128 * (tile & 3) + (tile >> 2); }
            else { stride = 1; res = 0; i0 = 512 * blk + 32 * tile; tstride = 1; tbase = 32 * tile; }
            f32x16 o0, o1; float m, l;
            band_tile(Qp, Kp, Vp, stride, res, i0, vst, wsf, lane, o0, o1, m, l);
            const int tl = r32 * tstride + tbase;
            const float lse = m + lg2(l);
            float wcur, wprev, lsen;
            if (st == 0) { lsen = lse; wcur = __builtin_amdgcn_rcpf(l); wprev = 0.f; }
            else { const float lp = lbuf[tl]; const float M = fmaxf(lp, lse); lsen = M + lg2(ex2(lp - M) + ex2(lse - M)); wprev = ex2(lp - lsen); wcur = ex2(m - lsen); }
            if (hi == 0) { if (st < 2) lbuf[tl] = lsen; wsf[r32] = wcur; wsf[32 + r32] = wprev; }
#pragma unroll
            for (int r = 0; r < 16; ++r) {
                const int qq = crow(r, hi);
                const float wc_ = wsf[qq], wp_ = wsf[32 + qq];
                ALDS u16* op = (ALDS u16*)(obuf + (qq * tstride + tbase) * 128) + r32;
                float v0 = o0[r] * wc_, v1 = o1[r] * wc_;
                if (st > 0) { v0 += bf2f(op[0]) * wp_; v1 += bf2f(op[32]) * wp_; }
                op[0] = (u16)(cvtpk(v0, 0.f) & 0xffffu); op[32] = (u16)(cvtpk(v1, 0.f) & 0xffffu);
            }
            if (st == 2) gate_store(obuf + tbase * 128, G, MIX, (size_t)b * SEQ + 512 * blk + tbase, h * 64, lane);
        }
        __syncthreads();
    }
}
__device__ __forceinline__ void b_unit(int u, const unsigned char* ws, const float* __restrict__ sinks, ALDS unsigned char* lds, int wave, int lane) {
    const int b = u >> 5, kvh = (u >> 4) & 1, blk = u & 15;
    const size_t kb = (size_t)(b * 2 + kvh) * SEQ * 64;
    const u16* Kp = (const u16*)(ws + WS_KB) + kb; const u16* Vp = (const u16*)(ws + WS_VB) + kb;
    const u16* G = (const u16*)(ws + WS_G); u16* MIX = (u16*)(ws + WS_MIX);
    ALDS unsigned char* vst = lds + L_WAVE + wave * L_WAVE_STRIDE; ALDS float* wsf = (ALDS float*)(vst + 4096);
    const int r32 = lane & 31, hi = lane >> 5;
    for (int tt = 0; tt < 4; ++tt) {
        const int hq = 4 * kvh + tt, i0 = 256 * blk + 32 * wave;
        const u16* Qp = (const u16*)(ws + WS_QB) + (size_t)(b * 8 + hq) * SEQ * 64;
        f32x16 o0, o1; float m, l;
        band_tile(Qp, Kp, Vp, 1, 0, i0, vst, wsf, lane, o0, o1, m, l);
        const float s2 = sinks[hq] * LOG2E, M2 = fmaxf(m, s2), f2 = ex2(m - M2);
        const float sc = f2 * __builtin_amdgcn_rcpf(l * f2 + ex2(s2 - M2));
        if (hi == 0) wsf[r32] = sc;
#pragma unroll
        for (int r = 0; r < 16; ++r) {
            const int qq = crow(r, hi); const float s_ = wsf[qq];
            ALDS u16* op = (ALDS u16*)(vst + qq * 128) + r32;
            op[0] = (u16)(cvtpk(o0[r] * s_, 0.f) & 0xffffu); op[32] = (u16)(cvtpk(o1[r] * s_, 0.f) & 0xffffu);
        }
        gate_store(vst, G, MIX, (size_t)b * SEQ + i0, 512 + hq * 64, lane);
    }
}
}

constexpr int NWAVES = 8;
constexpr int RING_OFF = 0, RING_BYTES = 131072;
constexpr int LDSCTL_OFF = RING_BYTES, MISC_OFF = LDSCTL_OFF + 320;
constexpr int LDS_BYTES = 147456;

struct Args { const float* x_prompt; const float* x_sample; const float* cache_a; const float* cache_b; const float* w_in; const float* sinks; const float* w_o; const float* ln_g; const float* ln_b;
              float* out; unsigned char* ws; int ph_lo, ph_hi; };

__device__ __forceinline__ void p0_prologue(const Args& a, LAS unsigned char* lds, int vcu, int G, int wave, int lane, int tid) {
    LAS float* scr = (LAS float*)(lds + RING_OFF + wave * 16384);
    const int gw = vcu * NWAVES + wave, NGW = G * NWAVES;
    bf16* WinT = (bf16*)(a.ws + WS_WIN); bf16* WoT = (bf16*)(a.ws + WS_WO); bf16* XB = (bf16*)(a.ws + WS_XB);
    constexpr int I_IN = (DM / 64) * (NIN / 32), I_O = (DM / 64) * (DM / 32);
    for (int it = gw; it < I_IN + I_O; it += NGW) {
        if (it < I_IN) p0_transpose_item(a.w_in, DM, NIN, WinT, 0, scr, it, lane);
        else p0_transpose_item(a.w_o, DM, DM, WoT, 0, scr, it - I_IN, lane);
    }
    for (int m = gw; m < MPAD; m += NGW) {
        GAS unsigned long long* o8 = (GAS unsigned long long*)(XB + (size_t)m * DM) + lane;
        if (m < MV) {
            const float* src = m < MP ? a.x_prompt + (size_t)m * DM : a.x_sample + (size_t)(m - MP) * DM;
            const GAS f32x4* xr = (const GAS f32x4*)src + lane;
            f32x4 v[4];
#pragma unroll
            for (int j = 0; j < 4; ++j) v[j] = xr[64 * j];
#pragma unroll
            for (int j = 0; j < 4; ++j) o8[64 * j] = (unsigned long long)pk2(v[j].x, v[j].y) | ((unsigned long long)pk2(v[j].z, v[j].w) << 32);
        } else {
#pragma unroll
            for (int j = 0; j < 4; ++j) o8[64 * j] = 0ull;
        }
    }
    float* rope = (float*)(a.ws + WS_ROPE);
    for (int idx = blockIdx.x * (NWAVES * 64) + tid; idx < (SEQ + 1) * 8; idx += G * NWAVES * 64) {
        const int p = idx >> 3, i = idx & 7;
        const double pos = (p == SEQ) ? 16384.0 : (double)p;
        const double ir = i == 0 ? 0.15915494309189535 : i == 1 ? 0.03086376340470123 : i == 2 ? 0.005985185712713705 : i == 3 ? 0.001160663641240061
                        : i == 4 ? 0.00022507907903927653 : i == 5 ? 4.364795279280289e-05 : i == 6 ? 8.464330808241401e-06 : 1.6414262627950345e-06;
        const double rev = pos * ir; const float fr = (float)(rev - __builtin_floor(rev));
        rope[p * 16 + i] = __builtin_amdgcn_cosf(fr); rope[p * 16 + 8 + i] = __builtin_amdgcn_sinf(fr);
    }
}

__device__ __forceinline__ void p4_layernorm(const Args& a, int vcu, int G, int wave, int lane) {
    const int gw = vcu * NWAVES + wave, NGW = G * NWAVES;
    f32x4 gg[4], bb[4];
#pragma unroll
    for (int j = 0; j < 4; ++j) { gg[j] = ((const f32x4*)a.ln_g)[lane + 64 * j]; bb[j] = ((const f32x4*)a.ln_b)[lane + 64 * j]; }
    for (int m = gw; m < MV; m += NGW) {
        GAS f32x4* xr = (GAS f32x4*)(a.out + OFF_Y + (size_t)m * DM) + lane;
        f32x4 v[4]; float s = 0.f;
#pragma unroll
        for (int j = 0; j < 4; ++j) { v[j] = xr[64 * j]; s += (v[j].x + v[j].y) + (v[j].z + v[j].w); }
        const float mean = wave_sum(s) * (1.f / DM); float s2 = 0.f;
#pragma unroll
        for (int j = 0; j < 4; ++j) { v[j] = v[j] - mean; s2 += (v[j].x * v[j].x + v[j].y * v[j].y) + (v[j].z * v[j].z + v[j].w * v[j].w); }
        const float rstd = 1.f / sqrtf(wave_sum(s2) * (1.f / DM) + LN_EPS);
#pragma unroll
        for (int j = 0; j < 4; ++j) xr[64 * j] = v[j] * rstd * gg[j] + bb[j];
    }
}

__global__ void __launch_bounds__(NWAVES * 64, 2) hymba_fwd(Args args) {
    extern __shared__ __attribute__((aligned(16))) unsigned char lds_raw[];
    LAS unsigned char* lds = (LAS unsigned char*)lds_raw;
    volatile LAS unsigned* MISC = (volatile LAS unsigned*)(lds + MISC_OFF);
    const int tid = threadIdx.x, lane = tid & 63, wave = __builtin_amdgcn_readfirstlane(tid >> 6);
    const int G = gridDim.x; const int bx = blockIdx.x; const int vcu = (G % 8 == 0) ? (bx % 8) * (G / 8) + bx / 8 : bx;
    gu32* ctl = (gu32*)(args.ws + WS_CTL);
    for (int u = tid; u < (LDS_BYTES - LDSCTL_OFF) / 4; u += NWAVES * 64) ((LAS unsigned*)(lds + LDSCTL_OFF))[u] = 0u;
    __syncthreads();
    XcdBarrier bar = xcd_barrier_post((unsigned*)(ctl + CW_BAR), MISC + 8);
    const int lo = args.ph_lo, hi = args.ph_hi;
#define IN(k) (lo <= (k) && (k) < hi)
#define BOTH(k) (IN(k) && IN((k) + 1))

    if (IN(0)) { p0_prologue(args, lds, vcu, G, wave, lane, tid); if (BOTH(0)) xcd_barrier(bar); }

    if (IN(1)) {
        pg8::Gemm g{(const pg8::bf16_t*)(args.ws + WS_XB), (const pg8::bf16_t*)(args.ws + WS_WIN), MPAD, NIN, DM};
        pg8::StaticOrder S; S.init(MPAD, NIN, G, bx);
        pg8::EpiIn E{args.out, args.ws, (const float*)(args.ws + WS_ROPE)};
        pg8::gemm_phase<pg8::EpiIn, pg8::StaticOrder, true, true>(lds + RING_OFF, g, S, E);
        if (BOTH(1)) xcd_barrier(bar);
    }

    if (IN(2)) {
        const att::u16* SQ = (const att::u16*)(args.ws + WS_SQ); const att::u16* Gt = (const att::u16*)(args.ws + WS_G); att::u16* MIX = (att::u16*)(args.ws + WS_MIX);
        for (int job = bx * NWAVES + wave; job < MS * 16; job += G * NWAVES) att::sample_job(job >> 4, job & 15, args.cache_a, args.cache_b, args.sinks, args.out, SQ, Gt, MIX, lane);
        __syncthreads();
        for (int u = bx; u < 512; u += G) att::a_unit(u, args.ws, lds, wave, lane);
        for (int u = bx; u < 256; u += G) att::b_unit(u, args.ws, args.sinks, lds, wave, lane);
        if (BOTH(2)) xcd_barrier(bar);
    }

    if (IN(3)) {
        pg8::Gemm g{(const pg8::bf16_t*)(args.ws + WS_MIX), (const pg8::bf16_t*)(args.ws + WS_WO), MPAD, DM, DM};
        pg8::StaticOrder S; S.init(MPAD, DM, G, bx);
        pg8::EpiOut E{args.x_prompt, args.x_sample, args.out};
        pg8::gemm_phase<pg8::EpiOut, pg8::StaticOrder, true, true>(lds + RING_OFF, g, S, E);
        if (BOTH(3)) xcd_barrier(bar);
    }

    if (IN(4)) p4_layernorm(args, vcu, G, wave, lane);
#undef IN
#undef BOTH
}

#ifndef N_LAUNCHES
#define N_LAUNCHES 1
#endif
extern "C" void kernel_launch(void* const* d_in, const int* in_sizes, int n_in, void* d_out, int out_size, void* d_ws, size_t ws_size, hipStream_t stream) {
    static int grid = 0;
    if (grid == 0) {
        if (n_in != 9 || (size_t)out_size != OUT_TOTAL || ws_size < WS_END) { fprintf(stderr, "kernel_launch: unexpected shapes (n_in %d, out %d, ws %zu); nothing launched\n", n_in, out_size, ws_size); grid = -1; return; }
        int dev = 0, cus = 0, per_cu = 0;
        if (hipGetDevice(&dev) != hipSuccess || hipDeviceGetAttribute(&cus, hipDeviceAttributeMultiprocessorCount, dev) != hipSuccess) { grid = -1; return; }
        if (hipFuncSetAttribute((const void*)hymba_fwd, hipFuncAttributeMaxDynamicSharedMemorySize, LDS_BYTES) != hipSuccess) { fprintf(stderr, "kernel_launch: hipFuncSetAttribute failed\n"); grid = -1; return; }
        if (hipOccupancyMaxActiveBlocksPerMultiprocessor(&per_cu, (const void*)hymba_fwd, NWAVES * 64, LDS_BYTES) != hipSuccess || per_cu < 1) { fprintf(stderr, "kernel_launch: occupancy query says %d blocks per CU\n", per_cu); (void)hipGetLastError(); grid = -1; return; }
        grid = cus;
    }
    if (grid < 0) return;
    if (hipMemsetAsync((char*)d_ws + WS_CTL, 0, CTL_ZERO_BYTES, stream) != hipSuccess) return;
    Args a{};
    a.x_prompt = (const float*)d_in[0]; a.x_sample = (const float*)d_in[1]; a.cache_a = (const float*)d_in[2]; a.cache_b = (const float*)d_in[3]; a.w_in = (const float*)d_in[4];
    a.sinks = (const float*)d_in[5]; a.w_o = (const float*)d_in[6]; a.ln_g = (const float*)d_in[7]; a.ln_b = (const float*)d_in[8];
    a.out = (float*)d_out; a.ws = (unsigned char*)d_ws;
#if N_LAUNCHES == 1
    a.ph_lo = 0; a.ph_hi = 5;
    hipLaunchKernelGGL(hymba_fwd, dim3(grid), dim3(NWAVES * 64), LDS_BYTES, stream, a);
#else
    for (int p = 0; p < 5; ++p) { a.ph_lo = p; a.ph_hi = p + 1; hipLaunchKernelGGL(hymba_fwd, dim3(grid), dim3(NWAVES * 64), LDS_BYTES, stream, a); }
#endif
}
```
